# Optimizing an MI355X kernel written in HIP

```python
import math
import jax, jax.numpy as jnp
from jax import lax
import numpy as np

D_MODEL = 1024
BATCH = 8
SEQ = 4096
DEPTH = 2
DEC_BATCH = 32
DEC_SEQ = 8
PAST_LEN = 16384
PAGE_SIZE = 128

HEAD_DIM = 64
N_HEAD_SLOTS = 8
DIL_GROUPS = ((128, 1), (512, 4), (2048, 16))
N_DIL = len(DIL_GROUPS)
ATTN_WIDTH = N_HEAD_SLOTS * HEAD_DIM
QKV_WIDTH = 3 * N_DIL * ATTN_WIDTH
ROPE_THETA = 10000.0
BLOCK_Q = 128
SSM_WIDTH = D_MODEL
SSM_GROUP = 16
SSM_GROUPS = SSM_WIDTH // SSM_GROUP
SSM_STATE = 64
SCAN_CHUNK = 128
D_FF = -(-8 * D_MODEL // (3 * 256)) * 256
RMS_EPS = 1e-6
N_ATTN_LAYERS = (DEPTH + 1) // 2
N_SSM_LAYERS = DEPTH // 2

kernel_name = 'dilated_attn_s5_hybrid_step'


def rmsnorm(x, g):
    xf = x.astype(jnp.float32)
    y = xf * lax.rsqrt(jnp.mean(xf * xf, axis=-1, keepdims=True) + RMS_EPS)
    return (y * g.astype(jnp.float32)).astype(x.dtype)


def rope(x, pos):
    half = HEAD_DIM // 2
    inv = ROPE_THETA ** (-jnp.arange(half, dtype=jnp.float32) / half)
    ang = pos.astype(jnp.float32)[:, None] * inv[None, :]
    cos = jnp.cos(ang)[None, :, None, None, :]
    sin = jnp.sin(ang)[None, :, None, None, :]
    xf = x.astype(jnp.float32)
    x1, x2 = xf[..., :half], xf[..., half:]
    return jnp.concatenate([x1 * cos - x2 * sin, x2 * cos + x1 * sin], axis=-1).astype(x.dtype)


def dilated_block(q_blk, kv_all, qi, dilation, n_keys):
    idx = qi[:, None] - dilation * jnp.arange(n_keys)[None, :]
    valid = idx >= 0
    kvg = jnp.take(kv_all, jnp.maximum(idx, 0), axis=1)
    kf = kvg[:, :, :, 0].astype(jnp.float32)
    vf = kvg[:, :, :, 1].astype(jnp.float32)
    s = jnp.einsum('bqhd,bqkhd->bqhk', q_blk.astype(jnp.float32), kf) * (HEAD_DIM ** -0.5)
    s = jnp.where(valid[None, :, None, :], s, -jnp.inf)
    lse = jax.nn.logsumexp(s, axis=-1)
    p = jnp.exp(s - lse[..., None])
    o = jnp.einsum('bqhk,bqkhd->bqhd', p, vf)
    return o, lse


def attention_layer(h, pos, bufs, w_qkv, q_gain, k_gain, w_o):
    B, T, _ = h.shape
    qkv = (h @ w_qkv).reshape(B, T, 3, N_DIL, N_HEAD_SLOTS, HEAD_DIM)
    q = rope(rmsnorm(qkv[:, :, 0], q_gain), pos)
    k = rope(rmsnorm(qkv[:, :, 1], k_gain), pos)
    v = qkv[:, :, 2]
    kv_alls, new_bufs, offs = [], [], []
    for g, (win, dil) in enumerate(DIL_GROUPS):
        kv_new = jnp.stack([k[:, :, g], v[:, :, g]], axis=2)
        kv_all = jnp.concatenate([bufs[g].astype(kv_new.dtype), kv_new], axis=1)
        kv_alls.append(kv_all)
        offs.append(bufs[g].shape[1])
        keep = min(win, kv_all.shape[1])
        new_bufs.append(kv_all[:, kv_all.shape[1] - keep:])
    qb = BLOCK_Q if T % BLOCK_Q == 0 else T
    n_blocks = T // qb

    def block(i):
        outs, lses = [], []
        for g, (win, dil) in enumerate(DIL_GROUPS):
            q_blk = lax.dynamic_slice_in_dim(q[:, :, g], i * qb, qb, axis=1)
            qi = offs[g] + i * qb + jnp.arange(qb)
            o, l = dilated_block(q_blk, kv_alls[g], qi, dil, win // dil + 1)
            outs.append(o)
            lses.append(l)
        wts = jax.nn.softmax(jnp.stack(lses, axis=0), axis=0)
        return jnp.einsum('gbqh,gbqhd->bqhd', wts, jnp.stack(outs, axis=0))

    o = lax.map(block, jnp.arange(n_blocks))
    o = jnp.moveaxis(o, 0, 1).reshape(B, T, ATTN_WIDTH).astype(h.dtype)
    return o @ w_o, new_bufs


def ssm_layer(h, state0, w_in, a_re, a_im, log_dt, b_re, b_im, c_re, c_im, d_skip, w_glu):
    B, T, _ = h.shape
    f32 = jnp.float32
    u = (h @ w_in).astype(f32)
    lam = lax.complex(a_re.astype(f32), a_im.astype(f32))
    dt = jnp.exp(log_dt.astype(f32))[:, None]
    abar = jnp.exp(lam * dt)
    bmat = lax.complex(b_re.astype(f32), b_im.astype(f32))
    bbar = ((abar - 1.0) / lam)[..., None] * bmat
    cmat = lax.complex(c_re.astype(f32), c_im.astype(f32))
    ch = SCAN_CHUNK if T % SCAN_CHUNK == 0 else T
    nc = T // ch
    uc = jnp.moveaxis(u.reshape(B, nc, ch, SSM_GROUPS, SSM_GROUP), 1, 0)

    def combine(e1, e2):
        a1, b1 = e1
        a2, b2 = e2
        return a1 * a2, a2 * b1 + b2

    def step(hc, uk):
        bu = jnp.einsum('gpc,btgc->btgp', bbar, uk.astype(jnp.complex64))
        a_el = jnp.broadcast_to(abar, bu.shape)
        a_cum, x0 = lax.associative_scan(combine, (a_el, bu), axis=1)
        xs = x0 + a_cum * hc[:, None]
        y = jnp.einsum('gcp,btgp->btgc', cmat, xs).real
        return xs[:, -1], y

    h_last, ys = lax.scan(step, state0, uc)
    y = jnp.moveaxis(ys, 0, 1).reshape(B, T, SSM_WIDTH) + d_skip.astype(f32) * u
    g = jax.nn.gelu(y).astype(h.dtype)
    z = g @ w_glu
    val, gate = jnp.split(z, 2, axis=-1)
    return val * jax.nn.sigmoid(gate), h_last


def swiglu(h, w_gate, w_up, w_down):
    return (jax.nn.silu(h @ w_gate) * (h @ w_up)) @ w_down


def trunk(x, pos, attn_bufs, ssm_states, p):
    new_attn, new_ssm = [], []
    for i in range(DEPTH):
        h = rmsnorm(x, p['norm_mix'][i])
        if i % 2 == 0:
            la = i // 2
            out, nb = attention_layer(h, pos, attn_bufs[la], p['w_qkv'][la], p['q_norm'][la],
                                      p['k_norm'][la], p['w_o'][la])
            new_attn.append(nb)
        else:
            lb = i // 2
            out, st = ssm_layer(h, ssm_states[lb], p['ssm_w_in'][lb], p['ssm_a_re'][lb],
                                p['ssm_a_im'][lb], p['ssm_log_dt'][lb], p['ssm_b_re'][lb],
                                p['ssm_b_im'][lb], p['ssm_c_re'][lb], p['ssm_c_im'][lb],
                                p['ssm_d'][lb], p['ssm_w_glu'][lb])
            new_ssm.append(st)
        x = x + out.astype(x.dtype)
        h2 = rmsnorm(x, p['norm_ffn'][i])
        x = x + swiglu(h2, p['ffn_w_gate'][i], p['ffn_w_up'][i], p['ffn_w_down'][i]).astype(x.dtype)
    return x, new_attn, new_ssm


def _stack_kv(kv_layers, g):
    return jnp.stack([layer[g] for layer in kv_layers], axis=0)


def _stack_state(states, dtype):
    return jnp.stack([jnp.stack([s.real, s.imag], axis=-1) for s in states], axis=0).astype(dtype)


def setup_inputs(seed: int = 0) -> dict:
    key = jax.random.key(seed)
    ks = jax.random.split(key, 26)
    f32 = jnp.float32

    def nrm(k, shape, scale):
        return jax.random.normal(k, shape, f32) * scale

    na, nb = N_ATTN_LAYERS, N_SSM_LAYERS

    def cache_shape(win):
        return (na, DEC_BATCH, min(win, PAST_LEN), 2, N_HEAD_SLOTS, HEAD_DIM)

    n_idx = jnp.arange(SSM_STATE, dtype=f32)
    G, P, C = SSM_GROUPS, SSM_STATE, SSM_GROUP
    return {
        'x_prompt': nrm(ks[0], (BATCH, SEQ, D_MODEL), 1.0),
        'x_sample': nrm(ks[1], (DEC_BATCH, DEC_SEQ, D_MODEL), 1.0),
        'cache_kv_w128': nrm(ks[2], cache_shape(DIL_GROUPS[0][0]), 1.0),
        'cache_kv_w512': nrm(ks[3], cache_shape(DIL_GROUPS[1][0]), 1.0),
        'cache_kv_w2048': nrm(ks[4], cache_shape(DIL_GROUPS[2][0]), 1.0),
        'state_ssm': nrm(ks[5], (nb, DEC_BATCH, G, P, 2), 1.0),
        'norm_mix': 1.0 + nrm(ks[6], (DEPTH, D_MODEL), 0.02),
        'norm_ffn': 1.0 + nrm(ks[7], (DEPTH, D_MODEL), 0.02),
        'w_qkv': nrm(ks[8], (na, D_MODEL, QKV_WIDTH), D_MODEL ** -0.5),
        'q_norm': 1.0 + nrm(ks[9], (na, HEAD_DIM), 0.02),
        'k_norm': 1.0 + nrm(ks[10], (na, HEAD_DIM), 0.02),
        'w_o': nrm(ks[11], (na, ATTN_WIDTH, D_MODEL), ATTN_WIDTH ** -0.5),
        'ssm_w_in': nrm(ks[12], (nb, D_MODEL, SSM_WIDTH), D_MODEL ** -0.5),
        'ssm_a_re': -0.5 + nrm(ks[13], (nb, G, P), 0.01),
        'ssm_a_im': math.pi * n_idx + nrm(ks[14], (nb, G, P), 0.01),
        'ssm_log_dt': jax.random.uniform(ks[15], (nb, G), f32, math.log(1e-3), math.log(1e-1)),
        'ssm_b_re': nrm(ks[16], (nb, G, P, C), (2 * C) ** -0.5),
        'ssm_b_im': nrm(ks[17], (nb, G, P, C), (2 * C) ** -0.5),
        'ssm_c_re': nrm(ks[18], (nb, G, C, P), (2 * P) ** -0.5),
        'ssm_c_im': nrm(ks[19], (nb, G, C, P), (2 * P) ** -0.5),
        'ssm_d': nrm(ks[20], (nb, SSM_WIDTH), 1.0),
        'ssm_w_glu': nrm(ks[21], (nb, SSM_WIDTH, 2 * D_MODEL), SSM_WIDTH ** -0.5),
        'ffn_w_gate': nrm(ks[22], (DEPTH, D_MODEL, D_FF), D_MODEL ** -0.5),
        'ffn_w_up': nrm(ks[23], (DEPTH, D_MODEL, D_FF), D_MODEL ** -0.5),
        'ffn_w_down': nrm(ks[24], (DEPTH, D_FF, D_MODEL), D_FF ** -0.5),
    }


def reference(x_prompt, x_sample, cache_kv_w128, cache_kv_w512, cache_kv_w2048, state_ssm,
              norm_mix, norm_ffn, w_qkv, q_norm, k_norm, w_o,
              ssm_w_in, ssm_a_re, ssm_a_im, ssm_log_dt, ssm_b_re, ssm_b_im, ssm_c_re, ssm_c_im,
              ssm_d, ssm_w_glu, ffn_w_gate, ffn_w_up, ffn_w_down):
    p = dict(norm_mix=norm_mix, norm_ffn=norm_ffn, w_qkv=w_qkv, q_norm=q_norm, k_norm=k_norm,
             w_o=w_o, ssm_w_in=ssm_w_in, ssm_a_re=ssm_a_re, ssm_a_im=ssm_a_im,
             ssm_log_dt=ssm_log_dt, ssm_b_re=ssm_b_re, ssm_b_im=ssm_b_im, ssm_c_re=ssm_c_re,
             ssm_c_im=ssm_c_im, ssm_d=ssm_d, ssm_w_glu=ssm_w_glu, ffn_w_gate=ffn_w_gate,
             ffn_w_up=ffn_w_up, ffn_w_down=ffn_w_down)
    bp = x_prompt.shape[0]
    empty = jnp.zeros((bp, 0, 2, N_HEAD_SLOTS, HEAD_DIM), x_prompt.dtype)
    prompt_bufs = [[empty for _ in range(N_DIL)] for _ in range(N_ATTN_LAYERS)]
    prompt_states = [jnp.zeros((bp, SSM_GROUPS, SSM_STATE), jnp.complex64) for _ in range(N_SSM_LAYERS)]
    pos_p = jnp.arange(x_prompt.shape[1])
    y_prompt, kv_p, st_p = trunk(x_prompt, pos_p, prompt_bufs, prompt_states, p)
    caches = (cache_kv_w128, cache_kv_w512, cache_kv_w2048)
    sample_bufs = [[c[l] for c in caches] for l in range(N_ATTN_LAYERS)]
    sample_states = [lax.complex(state_ssm[l, ..., 0].astype(jnp.float32),
                                 state_ssm[l, ..., 1].astype(jnp.float32)) for l in range(N_SSM_LAYERS)]
    pos_s = PAST_LEN + jnp.arange(x_sample.shape[1])
    y_sample, kv_s, st_s = trunk(x_sample, pos_s, sample_bufs, sample_states, p)
    return (y_prompt, y_sample,
            _stack_kv(kv_p, 0), _stack_kv(kv_p, 1), _stack_kv(kv_p, 2),
            _stack_state(st_p, x_prompt.dtype),
            _stack_kv(kv_s, 0), _stack_kv(kv_s, 1), _stack_kv(kv_s, 2),
            _stack_state(st_s, x_sample.dtype))
```

```cpp
#include <hip/hip_runtime.h>
#include <hip/hip_cooperative_groups.h>
#include <cstdio>
#include <cstdint>
namespace cg = cooperative_groups;

#define LAS __attribute__((address_space(3)))
typedef unsigned short bf16_t;
typedef short bf16x8 __attribute__((ext_vector_type(8)));
typedef short s16x4 __attribute__((ext_vector_type(4)));
typedef float f32x4 __attribute__((ext_vector_type(4)));
typedef float f32x2 __attribute__((ext_vector_type(2)));
typedef unsigned u32x4 __attribute__((ext_vector_type(4)));
typedef unsigned u32x2 __attribute__((ext_vector_type(2)));

constexpr int D = 1024, T = 4096, NB = 8, MP = NB * T, MS = 256, M = MP + MS, DFF = 2816, QKVW = 4608;
constexpr int NG = 64;
constexpr int CH = 16;
constexpr int NCR = MP / CH;
constexpr int UXP = 384;
constexpr float EPS = 1e-6f;
constexpr int LDS_BYTES = 131072;

constexpr size_t O_YP = 0;
constexpr size_t O_YS = O_YP + (size_t)MP * D;
constexpr size_t O_KVP0 = O_YS + (size_t)MS * D;
constexpr size_t O_KVP1 = O_KVP0 + (size_t)NB * 128 * 1024;
constexpr size_t O_KVP2 = O_KVP1 + (size_t)NB * 512 * 1024;
constexpr size_t O_STP = O_KVP2 + (size_t)NB * 2048 * 1024;
constexpr size_t O_KVS0 = O_STP + (size_t)NB * 64 * 64 * 2;
constexpr size_t O_KVS1 = O_KVS0 + (size_t)32 * 128 * 1024;
constexpr size_t O_KVS2 = O_KVS1 + (size_t)32 * 512 * 1024;
constexpr size_t O_STS = O_KVS2 + (size_t)32 * 2048 * 1024;
constexpr size_t O_END = O_STS + (size_t)32 * 64 * 64 * 2;

constexpr size_t al256(size_t x) { return (x + 255) & ~(size_t)255; }
constexpr size_t WS_WQKV = 0;
constexpr size_t WS_WO = WS_WQKV + (size_t)QKVW * D * 2;
constexpr size_t WS_WGU0 = WS_WO + (size_t)D * 512 * 2;
constexpr size_t WS_WGU1 = WS_WGU0 + (size_t)2 * DFF * D * 2;
constexpr size_t WS_WDN0 = WS_WGU1 + (size_t)2 * DFF * D * 2;
constexpr size_t WS_WDN1 = WS_WDN0 + (size_t)D * DFF * 2;
constexpr size_t WS_WIN = WS_WDN1 + (size_t)D * DFF * 2;
constexpr size_t WS_WGLU = WS_WIN + (size_t)D * D * 2;
constexpr size_t WS_BTS = WS_WGLU + (size_t)2 * D * D * 2;
constexpr size_t WS_BTY = WS_BTS + (size_t)NG * 256 * 256 * 2;
constexpr size_t WS_A16 = WS_BTY + (size_t)NG * 256 * UXP * 2;
constexpr size_t WS_ROPE = WS_A16 + (size_t)NG * 64 * 8;
constexpr size_t WS_ROWSS = WS_ROPE + (size_t)4104 * 32 * 8;
constexpr size_t WS_US = al256(WS_ROWSS + (size_t)4 * M * 4);
constexpr size_t WS_XB = WS_US + (size_t)MS * D * 4;
constexpr size_t WS_AO = WS_XB + (size_t)M * D * 2;
constexpr size_t WS_R = WS_AO + (size_t)M * 512 * 2;
constexpr size_t R_BYTES = (size_t)9 * 8 * M * 64 * 2;
constexpr size_t WS_QKVB = WS_R;
constexpr size_t WS_HFF = WS_R;
constexpr size_t WS_UX = WS_R;
constexpr size_t WS_SLOC = WS_UX + (size_t)NG * NCR * UXP * 2;
constexpr size_t WS_GB = WS_SLOC + (size_t)NG * NCR * 128 * 4;
constexpr size_t WS_END = WS_R + R_BYTES;
static_assert(WS_GB + (size_t)M * D * 2 <= WS_END, "aliased region too small");
static_assert((size_t)M * DFF * 2 <= R_BYTES, "aliased region too small");

#ifndef PH_MASK
#define PH_MASK 0xFFFF
#endif
struct Params { const float* in[25]; float* out; unsigned char* ws; };

__device__ __forceinline__ unsigned cvt_pk_bf16(float lo, float hi) { unsigned r; asm volatile("v_cvt_pk_bf16_f32 %0, %1, %2" : "=v"(r) : "v"(lo), "v"(hi)); return r; }
__device__ __forceinline__ bf16_t f2bf(float f) { unsigned u = __float_as_uint(f); u += 0x7FFFu + ((u >> 16) & 1u); return (bf16_t)(u >> 16); }
__device__ __forceinline__ float bf2f(unsigned short b) { return __uint_as_float(((unsigned)b) << 16); }
__device__ __forceinline__ float fast_exp2(float x) { return __builtin_amdgcn_exp2f(x); }
__device__ __forceinline__ float fast_rcp(float x) { return __builtin_amdgcn_rcpf(x); }
__device__ __forceinline__ float sigmoidf_(float x) { return fast_rcp(1.0f + fast_exp2(-1.44269504f * x)); }
__device__ __forceinline__ float gelu_tanh(float y) { const float z = 0.7978845608f * (y + 0.044715f * y * y * y); return y * fast_rcp(1.0f + fast_exp2(-2.885390082f * z)); }
__device__ __forceinline__ float wave_sum(float v) {
#pragma unroll
    for (int o = 32; o >= 1; o >>= 1) v += __shfl_xor(v, o);
    return v;
}
__device__ __forceinline__ float wave_max(float v) {
#pragma unroll
    for (int o = 32; o >= 1; o >>= 1) v = fmaxf(v, __shfl_xor(v, o));
    return v;
}

namespace pg8 {
constexpr int BM = 256, BK = 64, HALF = 128, HTB = HALF * BK * 2, STAGE_BYTES = 8 * HTB, NXCD = 8, WGM = 8;
__host__ __device__ __forceinline__ int lds_byte(int r, int c) { const int st = (r >> 4) * 2 + (c >> 5), rr = r & 15, cc = c & 31, ob = rr * 64 + cc * 2; return st * 1024 + (ob ^ (((ob >> 9) & 1) << 5)); }
__host__ __device__ __forceinline__ void stage_rc(int b, int& R, int& C) { const int st = b / 1024, sb = b % 1024, swz = sb ^ (((sb >> 9) & 1) << 5); R = (st >> 1) * 16 + swz / 64; C = (st & 1) * 32 + (swz % 64) / 2; }
struct Unit { int pm, pn; };
struct Gemm { const bf16_t* A; const bf16_t* Bt; int lda, ldb, K; };

struct StaticOrder {
    int nM, nN, nwg, G, c;
    __device__ void init(int nM_, int nN_, int G_, int c_) { nM = nM_; nN = nN_; nwg = nM * nN; G = G_; c = c_; }
    __device__ bool next(int i, Unit& u) const {
        const long L = (long)i * G + c; if (L >= nwg) return false;
        int wgid = (int)L; { const int q = nwg / NXCD, r = nwg % NXCD, xcd = wgid % NXCD, off = wgid / NXCD; wgid = (xcd < r ? xcd * (q + 1) : r * (q + 1) + (xcd - r) * q) + off; }
        const int nig = WGM * nN, gid = wgid / nig, fm = gid * WGM, gsz = (nM - fm) < WGM ? (nM - fm) : WGM;
        u.pm = fm + ((wgid % nig) % gsz); u.pn = (wgid % nig) / gsz; return true;
    }
};
struct GroupOrder {
    int G, c;
    __device__ bool next(int i, Unit& u) const { const int L = i * G + c; if (L >= NG * 8) return false; u.pm = L; u.pn = L >> 3; return true; }
};

template <class Epi, class Sched>
__device__ __forceinline__ void gemm_phase(LAS unsigned char* lds, const Gemm g, const Sched& S, const Epi& E) {
    const int tid = threadIdx.x, wid = __builtin_amdgcn_readfirstlane(tid >> 6), lane = tid & 63, wr = wid >> 2, wc = wid & 3, fr = lane & 15, fq = lane >> 4;
    const int K = g.K, nt = K / BK;
    unsigned voffA[2], voffB[2];
#pragma unroll
    for (int i = 0; i < 2; ++i) { int R, C; stage_rc(tid * 16 + i * 8192, R, C); voffA[i] = (unsigned)(R * g.lda + C) * 2u; voffB[i] = (unsigned)(R * g.ldb + C) * 2u; }
    const size_t kstep = (size_t)(BK * 2);
    const size_t hstepA = (size_t)HALF * g.lda * 2, hstepB = (size_t)HALF * g.ldb * 2;
    const unsigned ldsw = (unsigned)wid * 1024u;
    const int aoff = lds_byte(wr * 64 + fr, fq * 8), boff = lds_byte(wc * 32 + fr, fq * 8);
#define PG8_SA(b, h) (((b) * 2 + (h)) * HTB)
#define PG8_SB(b, h) ((4 + (b) * 2 + (h)) * HTB)
#define PG8_STAGE(bufoff, gbase, voff) do { _Pragma("unroll") for (int _i = 0; _i < 2; ++_i) \
        __builtin_amdgcn_global_load_lds((const unsigned*)((const char*)(gbase) + (voff)[_i]), (LAS unsigned*)(lds + (bufoff) + ldsw + _i * 8192), 16, 0, 0); } while (0)
#define PG8_LDA(dst, b, h) do { _Pragma("unroll") for (int m = 0; m < 4; ++m) _Pragma("unroll") for (int k = 0; k < 2; ++k) dst[m][k] = *(const LAS bf16x8*)(lds + PG8_SA(b, h) + aoff + m * 2048 + k * 1024); } while (0)
#define PG8_LDB(dst, b, h) do { _Pragma("unroll") for (int n = 0; n < 2; ++n) _Pragma("unroll") for (int k = 0; k < 2; ++k) dst[n][k] = *(const LAS bf16x8*)(lds + PG8_SB(b, h) + boff + n * 2048 + k * 1024); } while (0)
#define PG8_MMA(ai, bj, At, Bt) do { __builtin_amdgcn_s_setprio(1); _Pragma("unroll") for (int m = 0; m < 4; ++m) _Pragma("unroll") for (int n = 0; n < 2; ++n) _Pragma("unroll") for (int k = 0; k < 2; ++k) \
        acc[ai][bj][m][n] = __builtin_amdgcn_mfma_f32_16x16x32_bf16(Bt[n][k], At[m][k], acc[ai][bj][m][n], 0, 0, 0); __builtin_amdgcn_s_setprio(0); } while (0)
#define PG8_WAIT_V(n) asm volatile("s_waitcnt vmcnt(" #n ")" ::: "memory")
#define PG8_WAIT_L(n) asm volatile("s_waitcnt lgkmcnt(" #n ")" ::: "memory")
#define PG8_BAR __builtin_amdgcn_s_barrier()
#define PG8_SCHED __builtin_amdgcn_sched_barrier(0)
    Unit cur, nxt; int ui = 0;
    if (!S.next(0, cur)) return;
    f32x4 acc[2][2][4][2];
#pragma unroll
    for (int a = 0; a < 2; ++a)
#pragma unroll
        for (int b = 0; b < 2; ++b)
#pragma unroll
            for (int m = 0; m < 4; ++m)
#pragma unroll
                for (int n = 0; n < 2; ++n) acc[a][b][m][n] = (f32x4){0.f, 0.f, 0.f, 0.f};
    bf16x8 At[4][2], B0[2][2], B1[2][2];
    const char* cA = (const char*)g.A + (size_t)cur.pm * 2 * hstepA; const char* cB = (const char*)g.Bt + (size_t)cur.pn * 2 * hstepB;
    PG8_STAGE(PG8_SB(0, 0), cB, voffB); PG8_STAGE(PG8_SA(0, 0), cA, voffA); PG8_STAGE(PG8_SB(0, 1), cB + hstepB, voffB); PG8_STAGE(PG8_SA(0, 1), cA + hstepA, voffA);
    if (wr == 1) PG8_BAR;
    PG8_WAIT_V(4); PG8_BAR;
    PG8_STAGE(PG8_SB(1, 0), cB + kstep, voffB); PG8_STAGE(PG8_SA(1, 0), cA + kstep, voffA); PG8_STAGE(PG8_SB(1, 1), cB + hstepB + kstep, voffB);
    PG8_WAIT_V(6); PG8_BAR;
    for (;;) {
        const bool has_next = S.next(ui + 1, nxt);
        const char* nA = has_next ? (const char*)g.A + (size_t)nxt.pm * 2 * hstepA : cA; const char* nB = has_next ? (const char*)g.Bt + (size_t)nxt.pn * 2 * hstepB : cB;
#pragma unroll 1
        for (int t = 0; t < nt; t += 2) {
            const bool last = (t == nt - 2);
            const char* a1 = cA + (size_t)(t + 1) * kstep;
            const char* a2 = last ? nA : cA + (size_t)(t + 2) * kstep; const char* b2 = last ? nB : cB + (size_t)(t + 2) * kstep;
            const char* a3 = a2 + kstep; const char* b3 = b2 + kstep;
            PG8_LDB(B0, 0, 0); PG8_SCHED; PG8_LDA(At, 0, 0); PG8_STAGE(PG8_SA(1, 1), a1 + hstepA, voffA);
            PG8_WAIT_L(8); PG8_BAR; PG8_WAIT_L(0); PG8_MMA(0, 0, At, B0); PG8_BAR; PG8_SCHED;
            PG8_LDB(B1, 0, 1); PG8_STAGE(PG8_SB(0, 0), b2, voffB);
            PG8_BAR; PG8_WAIT_L(0); PG8_MMA(0, 1, At, B1); PG8_BAR;
            PG8_LDA(At, 0, 1); PG8_STAGE(PG8_SA(0, 0), a2, voffA);
            PG8_BAR; PG8_WAIT_L(0); PG8_MMA(1, 0, At, B0); PG8_BAR; PG8_SCHED;
            PG8_STAGE(PG8_SB(0, 1), b2 + hstepB, voffB);
            PG8_WAIT_V(6); PG8_BAR; PG8_MMA(1, 1, At, B1); PG8_BAR;
            PG8_LDB(B0, 1, 0); PG8_SCHED; PG8_LDA(At, 1, 0); PG8_STAGE(PG8_SA(0, 1), a2 + hstepA, voffA);
            PG8_WAIT_L(8); PG8_BAR; PG8_WAIT_L(0); PG8_MMA(0, 0, At, B0); PG8_BAR; PG8_SCHED;
            PG8_LDB(B1, 1, 1); PG8_STAGE(PG8_SB(1, 0), b3, voffB);
            PG8_BAR; PG8_WAIT_L(0); PG8_MMA(0, 1, At, B1); PG8_BAR;
            PG8_LDA(At, 1, 1); PG8_STAGE(PG8_SA(1, 0), a3, voffA);
            PG8_BAR; PG8_WAIT_L(0); PG8_MMA(1, 0, At, B0); PG8_BAR; PG8_SCHED;
            PG8_STAGE(PG8_SB(1, 1), b3 + hstepB, voffB);
            PG8_WAIT_V(6); PG8_BAR; PG8_MMA(1, 1, At, B1); PG8_BAR;
        }
        E(acc, cur, wr, wc, fr, fq);
        if (!has_next) break;
#pragma unroll
        for (int a = 0; a < 2; ++a)
#pragma unroll
            for (int b = 0; b < 2; ++b)
#pragma unroll
                for (int m = 0; m < 4; ++m)
#pragma unroll
                    for (int n = 0; n < 2; ++n) acc[a][b][m][n] = (f32x4){0.f, 0.f, 0.f, 0.f};
        cur = nxt; cA = nA; cB = nB; ++ui;
    }
    PG8_WAIT_V(0);
    if (wr == 0) PG8_BAR;
    PG8_BAR;
#undef PG8_SA
#undef PG8_SB
#undef PG8_STAGE
#undef PG8_LDA
#undef PG8_LDB
#undef PG8_MMA
#undef PG8_WAIT_V
#undef PG8_WAIT_L
#undef PG8_BAR
#undef PG8_SCHED
}
}
using pg8::Unit;
typedef f32x4 Acc[2][2][4][2];

struct EpiQKV {
    const float* rowss; const float* qg; const float* kg; const f32x2* rope; bf16_t* qkvb; float* out;
    __device__ __forceinline__ void operator()(const Acc& acc, const Unit& u, int wr, int wc, int fr, int fq) const {
        const int which = u.pn / 6, grp = (u.pn % 6) >> 1, head = (u.pn & 1) * 4 + wc;
        bf16_t* dst = qkvb + ((size_t)((which * 3 + grp) * 8 + head) * M) * 64;
        const float* gain = which == 0 ? qg : kg;
        const int keep = grp == 0 ? 128 : (grp == 1 ? 512 : 2048);
        const size_t okp = grp == 0 ? O_KVP0 : (grp == 1 ? O_KVP1 : O_KVP2), oks = grp == 0 ? O_KVS0 : (grp == 1 ? O_KVS1 : O_KVS2);
        f32x4 gv[2][2];
#pragma unroll
        for (int bj = 0; bj < 2; ++bj)
#pragma unroll
            for (int n = 0; n < 2; ++n) gv[bj][n] = which < 2 ? *(const f32x4*)(gain + 32 * bj + 16 * n + 4 * fq) : (f32x4){1.f, 1.f, 1.f, 1.f};
#pragma unroll
        for (int ai = 0; ai < 2; ++ai)
#pragma unroll
            for (int m = 0; m < 4; ++m) {
                const int row = u.pm * 256 + ai * 128 + wr * 64 + m * 16 + fr;
                const float rstd = rsqrtf(rowss[row] * (1.0f / D) + EPS);
                f32x4 v[2][2];
#pragma unroll
                for (int bj = 0; bj < 2; ++bj)
#pragma unroll
                    for (int n = 0; n < 2; ++n) v[bj][n] = acc[ai][bj][m][n] * rstd;
                int posidx, b, t;
                if (row < MP) { b = row >> 12; t = row & 4095; posidx = t; } else { const int rs = row - MP; b = rs >> 3; t = rs & 7; posidx = 4096 + t; }
                if (which < 2) {
                    float ss = 0.f;
#pragma unroll
                    for (int bj = 0; bj < 2; ++bj)
#pragma unroll
                        for (int n = 0; n < 2; ++n) { const f32x4 x = v[bj][n]; ss += (x[0] * x[0] + x[1] * x[1]) + (x[2] * x[2] + x[3] * x[3]); }
                    ss += __shfl_xor(ss, 16); ss += __shfl_xor(ss, 32);
                    const float r2 = rsqrtf(ss * (1.0f / 64.0f) + EPS);
#pragma unroll
                    for (int bj = 0; bj < 2; ++bj)
#pragma unroll
                        for (int n = 0; n < 2; ++n) v[bj][n] = v[bj][n] * gv[bj][n] * r2;
#pragma unroll
                    for (int n = 0; n < 2; ++n) {
                        const f32x4* rp = (const f32x4*)(rope + (size_t)posidx * 32 + 16 * n + 4 * fq);
                        const f32x4 cs0 = rp[0], cs1 = rp[1];
                        const f32x4 x1 = v[0][n], x2 = v[1][n];
                        f32x4 y1, y2;
                        y1[0] = x1[0] * cs0[0] - x2[0] * cs0[1]; y2[0] = x2[0] * cs0[0] + x1[0] * cs0[1];
                        y1[1] = x1[1] * cs0[2] - x2[1] * cs0[3]; y2[1] = x2[1] * cs0[2] + x1[1] * cs0[3];
                        y1[2] = x1[2] * cs1[0] - x2[2] * cs1[1]; y2[2] = x2[2] * cs1[0] + x1[2] * cs1[1];
                        y1[3] = x1[3] * cs1[2] - x2[3] * cs1[3]; y2[3] = x2[3] * cs1[2] + x1[3] * cs1[3];
                        v[0][n] = y1; v[1][n] = y2;
                    }
                }
                bf16_t* rowp = dst + (size_t)row * 64 + 4 * fq;
#pragma unroll
                for (int bj = 0; bj < 2; ++bj)
#pragma unroll
                    for (int n = 0; n < 2; ++n) { u32x2 w; w.x = cvt_pk_bf16(v[bj][n][0], v[bj][n][1]); w.y = cvt_pk_bf16(v[bj][n][2], v[bj][n][3]); *(u32x2*)(rowp + 32 * bj + 16 * n) = w; }
                if (which >= 1) {
                    float* op = nullptr;
                    if (row < MP) { if (t >= T - keep) op = out + okp + ((size_t)(b * keep + (t - (T - keep))) * 2 + (which - 1)) * 512; }
                    else op = out + oks + ((size_t)(b * keep + (keep - 8 + t)) * 2 + (which - 1)) * 512;
                    if (op) { op += head * 64 + 4 * fq;
#pragma unroll
                        for (int bj = 0; bj < 2; ++bj)
#pragma unroll
                            for (int n = 0; n < 2; ++n) *(f32x4*)(op + 32 * bj + 16 * n) = v[bj][n]; }
                }
            }
    }
};

template <int MODE  , bool NEXT  >
struct EpiRes {
    const float* xp; const float* xs;
    float* out; bf16_t* xb; float* rowss_next;
    __device__ __forceinline__ void operator()(const Acc& acc, const Unit& u, int wr, int wc, int fr, int fq) const {
#pragma unroll
        for (int ai = 0; ai < 2; ++ai)
#pragma unroll
            for (int m = 0; m < 4; ++m) {
                const int row = u.pm * 256 + ai * 128 + wr * 64 + m * 16 + fr;
                const float* xin = row < MP ? xp + (size_t)row * D : xs + (size_t)(row - MP) * D;
                float ss = 0.f;
                if (MODE == 0) {
#pragma unroll
                    for (int bj = 0; bj < 2; ++bj)
#pragma unroll
                        for (int n = 0; n < 2; ++n) {
                            const int col = u.pn * 256 + bj * 128 + wc * 32 + n * 16 + 4 * fq;
                            const f32x4 x = *(const f32x4*)(xin + col) + acc[ai][bj][m][n];
                            *(f32x4*)(out + (size_t)row * D + col) = x;
                            if (NEXT) { u32x2 w; w.x = cvt_pk_bf16(x[0], x[1]); w.y = cvt_pk_bf16(x[2], x[3]); *(u32x2*)(xb + (size_t)row * D + col) = w;
                                ss += (x[0] * x[0] + x[1] * x[1]) + (x[2] * x[2] + x[3] * x[3]); }
                        }
                } else {
#pragma unroll
                    for (int n = 0; n < 2; ++n) {
                        const int col = u.pn * 128 + wc * 32 + n * 16 + 4 * fq;
                        const f32x4 val = acc[ai][0][m][n], gate = acc[ai][1][m][n];
                        f32x4 x = *(const f32x4*)(xin + col);
#pragma unroll
                        for (int j = 0; j < 4; ++j) x[j] += val[j] * sigmoidf_(gate[j]);
                        *(f32x4*)(out + (size_t)row * D + col) = x;
                        if (NEXT) { u32x2 w; w.x = cvt_pk_bf16(x[0], x[1]); w.y = cvt_pk_bf16(x[2], x[3]); *(u32x2*)(xb + (size_t)row * D + col) = w;
                            ss += (x[0] * x[0] + x[1] * x[1]) + (x[2] * x[2] + x[3] * x[3]); }
                    }
                }
                if (NEXT) { ss += __shfl_xor(ss, 16); ss += __shfl_xor(ss, 32); if (fq == 0) atomicAdd(rowss_next + row, ss); }
            }
    }
};

struct EpiUp {
    const float* rowss; bf16_t* hff;
    __device__ __forceinline__ void operator()(const Acc& acc, const Unit& u, int wr, int wc, int fr, int fq) const {
#pragma unroll
        for (int ai = 0; ai < 2; ++ai)
#pragma unroll
            for (int m = 0; m < 4; ++m) {
                const int row = u.pm * 256 + ai * 128 + wr * 64 + m * 16 + fr;
                const float rstd = rsqrtf(rowss[row] * (1.0f / D) + EPS);
#pragma unroll
                for (int n = 0; n < 2; ++n) {
                    const f32x4 g = acc[ai][0][m][n] * rstd, up = acc[ai][1][m][n] * rstd; f32x4 a;
#pragma unroll
                    for (int j = 0; j < 4; ++j) a[j] = g[j] * sigmoidf_(g[j]) * up[j];
                    u32x2 w; w.x = cvt_pk_bf16(a[0], a[1]); w.y = cvt_pk_bf16(a[2], a[3]);
                    *(u32x2*)(hff + (size_t)row * DFF + u.pn * 128 + wc * 32 + n * 16 + 4 * fq) = w;
                }
            }
    }
};

struct EpiWin {
    const float* rowss; bf16_t* ux; float* us;
    __device__ __forceinline__ void operator()(const Acc& acc, const Unit& u, int wr, int wc, int fr, int fq) const {
#pragma unroll
        for (int ai = 0; ai < 2; ++ai)
#pragma unroll
            for (int m = 0; m < 4; ++m) {
                const int row = u.pm * 256 + ai * 128 + wr * 64 + m * 16 + fr;
                const float rstd = rsqrtf(rowss[row] * (1.0f / D) + EPS);
#pragma unroll
                for (int bj = 0; bj < 2; ++bj)
#pragma unroll
                    for (int n = 0; n < 2; ++n) {
                        const int ch = u.pn * 256 + bj * 128 + wc * 32 + n * 16 + 4 * fq;
                        const f32x4 v = acc[ai][bj][m][n] * rstd;
                        if (row < MP) { u32x2 w; w.x = cvt_pk_bf16(v[0], v[1]); w.y = cvt_pk_bf16(v[2], v[3]);
                            *(u32x2*)(ux + ((size_t)(ch >> 4) * NCR + (row >> 4)) * UXP + (row & 15) * 16 + (ch & 15)) = w; }
                        else *(f32x4*)(us + (size_t)(row - MP) * D + ch) = v;
                    }
            }
    }
};

struct EpiSloc {
    float* sloc;
    __device__ __forceinline__ void operator()(const Acc& acc, const Unit& u, int wr, int wc, int fr, int fq) const {
#pragma unroll
        for (int ai = 0; ai < 2; ++ai)
#pragma unroll
            for (int m = 0; m < 4; ++m) {
                const size_t row = (size_t)u.pm * 256 + ai * 128 + wr * 64 + m * 16 + fr;
#pragma unroll
                for (int n = 0; n < 2; ++n) *(f32x4*)(sloc + row * 128 + wc * 32 + n * 16 + 4 * fq) = acc[ai][0][m][n];
            }
    }
};

struct EpiY {
    const bf16_t* ux; const float* dsk; bf16_t* gb;
    __device__ __forceinline__ void operator()(const Acc& acc, const Unit& u, int wr, int wc, int fr, int fq) const {
        const int g = u.pn;
        const f32x4 dv = *(const f32x4*)(dsk + g * 16 + 4 * fq);
        const int cr0 = (u.pm & 7) * 256 + wr * 64 + fr;
        const unsigned char* ub = (const unsigned char*)ux + (((size_t)g * NCR + cr0) * UXP + 2 * wc * 16 + 4 * fq) * 2;
        unsigned char* gbb = (unsigned char*)gb + (((size_t)cr0 * 16 + 2 * wc) * D + g * 16 + 4 * fq) * 2;
#pragma unroll
        for (int ai = 0; ai < 2; ++ai)
#pragma unroll
            for (int m = 0; m < 4; ++m) {
                asm volatile("" ::: "memory");
#pragma unroll
                for (int bj = 0; bj < 2; ++bj)
#pragma unroll
                    for (int n = 0; n < 2; ++n) {
                        const unsigned uo = (unsigned)(((ai * 128 + m * 16) * UXP + (8 * bj + n) * 16) * 2);
                        const unsigned go = (unsigned)((((ai * 128 + m * 16) * 16 + 8 * bj + n) * D) * 2);
                        const u32x2 uu = *(const u32x2*)(ub + uo);
                        f32x4 y = acc[ai][bj][m][n];
                        y[0] += dv[0] * __uint_as_float(uu.x << 16); y[1] += dv[1] * __uint_as_float(uu.x & 0xffff0000u);
                        y[2] += dv[2] * __uint_as_float(uu.y << 16); y[3] += dv[3] * __uint_as_float(uu.y & 0xffff0000u);
                        u32x2 w; w.x = cvt_pk_bf16(gelu_tanh(y[0]), gelu_tanh(y[1])); w.y = cvt_pk_bf16(gelu_tanh(y[2]), gelu_tanh(y[3]));
                        *(u32x2*)(gbb + go) = w;
                    }
            }
    }
};

struct WSel { const float* src0; const float* src1; const float* gain; bf16_t* dst; int K, Np, srcN, mode; };
__device__ __forceinline__ int wsel_get(const Params& P, int tile, WSel& w, int& kt, int& ntile) {
    const int cnt[8] = {1152, 128, 1408, 1408, 704, 704, 256, 512};
    int id = 0, t = tile;
#pragma unroll
    for (int i = 0; i < 8; ++i) { if (id == i && t >= cnt[i]) { t -= cnt[i]; id = i + 1; } }
    if (id >= 8) return -1;
    w.src1 = nullptr; w.gain = nullptr;
    switch (id) {
        case 0: w.src0 = P.in[8]; w.gain = P.in[6]; w.dst = (bf16_t*)(P.ws + WS_WQKV); w.K = 1024; w.Np = QKVW; w.srcN = QKVW; w.mode = 1; break;
        case 1: w.src0 = P.in[11]; w.dst = (bf16_t*)(P.ws + WS_WO); w.K = 512; w.Np = 1024; w.srcN = 1024; w.mode = 0; break;
        case 2: case 3: { const int l = id - 2; w.src0 = P.in[22] + (size_t)l * D * DFF; w.src1 = P.in[23] + (size_t)l * D * DFF; w.gain = P.in[7] + l * D;
            w.dst = (bf16_t*)(P.ws + (l ? WS_WGU1 : WS_WGU0)); w.K = 1024; w.Np = 2 * DFF; w.srcN = DFF; w.mode = 2; break; }
        case 4: case 5: { const int l = id - 4; w.src0 = P.in[24] + (size_t)l * DFF * D; w.dst = (bf16_t*)(P.ws + (l ? WS_WDN1 : WS_WDN0)); w.K = DFF; w.Np = 1024; w.srcN = 1024; w.mode = 0; break; }
        case 6: w.src0 = P.in[12]; w.gain = P.in[6] + D; w.dst = (bf16_t*)(P.ws + WS_WIN); w.K = 1024; w.Np = 1024; w.srcN = 1024; w.mode = 0; break;
        default: w.src0 = P.in[21]; w.dst = (bf16_t*)(P.ws + WS_WGLU); w.K = 1024; w.Np = 2048; w.srcN = 2048; w.mode = 3; break;
    }
    const int nkt = w.K / 64; kt = t % nkt; ntile = t / nkt; return id;
}

__device__ void prep_weights(const Params& P, LAS float* lf) {
    const int tid = threadIdx.x;
    for (int tile = blockIdx.x; tile < 6272; tile += gridDim.x) {
        WSel w; int kt, ntl; wsel_get(P, tile, w, kt, ntl);
        const int k0 = kt * 64, n0 = ntl * 64;
#pragma unroll
        for (int i = 0; i < 8; ++i) {
            const int idx = tid + 512 * i, kk = idx >> 6, nn = idx & 63, np = n0 + nn;
            const float* src = w.src0; int col = np;
            if (w.mode == 1) { const int tl = np >> 8, rho = np & 255; col = tl * 256 + 64 * ((rho >> 5) & 3) + 32 * (rho >> 7) + (rho & 31); }
            else if (w.mode == 2) { const int tl = np >> 8, rho = np & 255; col = tl * 128 + (rho & 127); if (rho >> 7) src = w.src1; }
            else if (w.mode == 3) { const int tl = np >> 8, rho = np & 255; col = (rho >> 7) * 1024 + tl * 128 + (rho & 127); }
            float v = src[(size_t)(k0 + kk) * w.srcN + col];
            if (w.gain) v *= w.gain[k0 + kk];
            lf[kk * 65 + nn] = v;
        }
        __syncthreads();
#pragma unroll
        for (int i = 0; i < 4; ++i) {
            const int idx = tid + 512 * i, nn = idx >> 5, kp = idx & 31;
            const unsigned pk = cvt_pk_bf16(lf[(2 * kp) * 65 + nn], lf[(2 * kp + 1) * 65 + nn]);
            *(unsigned*)(w.dst + (size_t)(n0 + nn) * w.K + k0 + 2 * kp) = pk;
        }
        __syncthreads();
    }
}

__device__ void prep_ssm(const Params& P, LAS float* lf, int g) {
    LAS f32x2* apow = (LAS f32x2*)lf; LAS f32x2* bbar = apow + 17 * 64; LAS f32x2* cm = bbar + 64 * 16; LAS float* kg = (LAS float*)(cm + 16 * 64);
    const int tid = threadIdx.x;
    const float* a_re = P.in[13]; const float* a_im = P.in[14]; const float* log_dt = P.in[15];
    const float* b_re = P.in[16]; const float* b_im = P.in[17]; const float* c_re = P.in[18]; const float* c_im = P.in[19];
    const float dt = expf(log_dt[g]);
    for (int i = tid; i < 17 * 64; i += 512) { const int tau = i >> 6, p = i & 63; const float lr = a_re[g * 64 + p] * dt * tau, li = a_im[g * 64 + p] * dt * tau; const float e = expf(lr); float s, c; sincosf(li, &s, &c); apow[i] = (f32x2){e * c, e * s}; }
    for (int i = tid; i < 1024; i += 512) { const int p = i >> 4;
        const float lr = a_re[g * 64 + p], li = a_im[g * 64 + p]; const float e = expf(lr * dt); float s, c; sincosf(li * dt, &s, &c);
        const float nr = e * c - 1.0f, ni = e * s, den = 1.0f / (lr * lr + li * li);
        const float qr = (nr * lr + ni * li) * den, qi = (ni * lr - nr * li) * den;
        const float br = b_re[(size_t)g * 1024 + i], bi = b_im[(size_t)g * 1024 + i];
        bbar[i] = (f32x2){qr * br - qi * bi, qr * bi + qi * br}; }
    for (int i = tid; i < 1024; i += 512) cm[i] = (f32x2){c_re[(size_t)g * 1024 + i], c_im[(size_t)g * 1024 + i]};
    __syncthreads();
    for (int i = tid; i < 4096; i += 512) { const int tau = i >> 8, co = (i >> 4) & 15, ci = i & 15; float s = 0.f;
        for (int p = 0; p < 64; ++p) { const f32x2 a = apow[tau * 64 + p], b = bbar[p * 16 + ci], c = cm[co * 64 + p];
            const float tr = a.x * b.x - a.y * b.y, ti = a.x * b.y + a.y * b.x; s += c.x * tr - c.y * ti; }
        kg[i] = s; }
    __syncthreads();
    bf16_t* bty = (bf16_t*)(P.ws + WS_BTY) + (size_t)g * 256 * UXP;
    for (int i = tid; i < 256 * UXP; i += 512) { const int n = i / UXP, k = i - n * UXP, tout = n >> 4, co = n & 15; float v;
        if (k < 256) { const int tin = k >> 4, ci = k & 15; v = tout >= tin ? kg[((tout - tin) * 16 + co) * 16 + ci] : 0.f; }
        else { const int kk = k - 256, p = kk >> 1; const f32x2 a = apow[(tout + 1) * 64 + p], c = cm[co * 64 + p];
            v = (kk & 1) ? -(c.x * a.y + c.y * a.x) : (c.x * a.x - c.y * a.y); }
        bty[i] = f2bf(v); }
    bf16_t* bts = (bf16_t*)(P.ws + WS_BTS) + (size_t)g * 256 * 256;
    for (int i = tid; i < 256 * 256; i += 512) { const int n = i >> 8, k = i & 255; float v = 0.f;
        if (n < 128) { const int p = n >> 1, tin = k >> 4, ci = k & 15; const f32x2 a = apow[(15 - tin) * 64 + p], b = bbar[p * 16 + ci];
            v = (n & 1) ? (a.x * b.y + a.y * b.x) : (a.x * b.x - a.y * b.y); }
        bts[i] = f2bf(v); }
    if (tid < 64) ((f32x2*)(P.ws + WS_A16))[g * 64 + tid] = apow[16 * 64 + tid];
    __syncthreads();
}

__device__ void prep_misc(const Params& P) {
    const int tid = threadIdx.x, wid = tid >> 6, lane = tid & 63;
    const size_t gtid = (size_t)blockIdx.x * 512 + tid, gsz = (size_t)gridDim.x * 512;
    bf16_t* xb = (bf16_t*)(P.ws + WS_XB); float* rowss = (float*)(P.ws + WS_ROWSS);
    for (int row = blockIdx.x * 8 + wid; row < M; row += gridDim.x * 8) {
        const float* xr = row < MP ? P.in[0] + (size_t)row * D : P.in[1] + (size_t)(row - MP) * D;
        float ss = 0.f;
#pragma unroll
        for (int i = 0; i < 4; ++i) { const f32x4 x = *(const f32x4*)(xr + i * 256 + lane * 4); ss += (x[0] * x[0] + x[1] * x[1]) + (x[2] * x[2] + x[3] * x[3]);
            u32x2 w; w.x = cvt_pk_bf16(x[0], x[1]); w.y = cvt_pk_bf16(x[2], x[3]); *(u32x2*)(xb + (size_t)row * D + i * 256 + lane * 4) = w; }
        ss = wave_sum(ss);
        if (lane == 0) rowss[row] = ss;
    }
    for (size_t i = gtid; i < (size_t)3 * M; i += gsz) rowss[M + i] = 0.f;
    f32x2* rope = (f32x2*)(P.ws + WS_ROPE);
    for (size_t i = gtid; i < (size_t)4104 * 32; i += gsz) { const int pi = (int)(i >> 5), f = (int)(i & 31); const int pos = pi < 4096 ? pi : 16384 + (pi - 4096);
        const float inv = powf(10000.0f, -(float)f / 32.0f); const float ang = (float)pos * inv; float s, c; sincosf(ang, &s, &c); rope[i] = (f32x2){c, s}; }
#pragma unroll
    for (int gi = 0; gi < 3; ++gi) {
        const int win = gi == 0 ? 128 : (gi == 1 ? 512 : 2048); const float* src = P.in[2 + gi]; float* dst = P.out + (gi == 0 ? O_KVS0 : (gi == 1 ? O_KVS1 : O_KVS2));
        const size_t per_b = (size_t)(win - 8) * 256, tot = per_b * 32;
        for (size_t i = gtid; i < tot; i += gsz) { const size_t b = i / per_b, r = i - b * per_b;
            ((f32x4*)dst)[b * (size_t)win * 256 + r] = __builtin_nontemporal_load((const f32x4*)src + b * (size_t)win * 256 + 2048 + r); }
    }
}

__device__ __forceinline__ s16x4 vtr(const LAS unsigned char* p) { typedef short v4i16_t __attribute__((ext_vector_type(4)));
    return __builtin_bit_cast(s16x4, __builtin_amdgcn_ds_read_tr16_b64_v4i16((LAS v4i16_t*)p)); }

__device__ __forceinline__ void attn_prompt_task(const bf16_t* __restrict__ qkvb, bf16_t* __restrict__ ao, LAS unsigned char* vl, int b, int h, int t0, int lane) {
    const int fr = lane & 15, fq = lane >> 4;
    const float SC = 0.125f * 1.44269504f;
    f32x4 o[4];
#pragma unroll
    for (int i = 0; i < 4; ++i) o[i] = (f32x4){0.f, 0.f, 0.f, 0.f};
    float mrun = -INFINITY, lrun = 0.f;
    const int tq = t0 + 16 * fr;
    const LAS unsigned char* vrd = vl + (4 * fq + ((lane & 15) >> 2)) * 144 + (lane & 3) * 8;
#pragma unroll 1
    for (int g = 0; g < 3; ++g) {
        const int dsh = 2 * g, d = 1 << dsh, qstride = 16 >> dsh;
        const int cls = t0 & (d - 1), sq0 = t0 >> dsh;
        const bf16_t* qp = qkvb + ((size_t)((0 * 3 + g) * 8 + h) * M + (size_t)b * T) * 64;
        const bf16_t* kp = qkvb + ((size_t)((1 * 3 + g) * 8 + h) * M + (size_t)b * T + cls) * 64;
        const bf16_t* vp = qkvb + ((size_t)((2 * 3 + g) * 8 + h) * M + (size_t)b * T + cls) * 64;
        const bf16x8 q0 = *(const bf16x8*)(qp + (size_t)tq * 64 + fq * 8), q1 = *(const bf16x8*)(qp + (size_t)tq * 64 + 32 + fq * 8);
        const int sq = sq0 + fr * qstride;
        const int hi = sq0 + 15 * qstride;
        int lo = sq0 - 128; lo = (lo < 0 ? 0 : lo) & ~31;
#pragma unroll 1
        for (int c0 = lo; c0 <= hi; c0 += 32) {
            const bf16_t* ka = kp + ((size_t)(c0 + fr) << dsh) * 64 + fq * 8;
            const bf16_t* kb = kp + ((size_t)(c0 + 16 + fr) << dsh) * 64 + fq * 8;
            const bf16x8 ka0 = *(const bf16x8*)ka, ka1 = *(const bf16x8*)(ka + 32), kb0 = *(const bf16x8*)kb, kb1 = *(const bf16x8*)(kb + 32);
            u32x4 vv[4];
#pragma unroll
            for (int i = 0; i < 4; ++i) { const int c = lane + 64 * i, key = c >> 3, part = c & 7; vv[i] = *(const u32x4*)(vp + ((size_t)(c0 + key) << dsh) * 64 + part * 8); }
            f32x4 sa = (f32x4){0.f, 0.f, 0.f, 0.f}, sb = (f32x4){0.f, 0.f, 0.f, 0.f};
            sa = __builtin_amdgcn_mfma_f32_16x16x32_bf16(ka0, q0, sa, 0, 0, 0); sa = __builtin_amdgcn_mfma_f32_16x16x32_bf16(ka1, q1, sa, 0, 0, 0);
            sb = __builtin_amdgcn_mfma_f32_16x16x32_bf16(kb0, q0, sb, 0, 0, 0); sb = __builtin_amdgcn_mfma_f32_16x16x32_bf16(kb1, q1, sb, 0, 0, 0);
            asm volatile("" ::: "memory");
#pragma unroll
            for (int i = 0; i < 4; ++i) { const int c = lane + 64 * i, key = c >> 3, part = c & 7; *(LAS u32x4*)(vl + key * 144 + part * 16) = vv[i]; }
            float mx = -INFINITY;
#pragma unroll
            for (int j = 0; j < 4; ++j) {
                const int ia = c0 + 4 * fq + j, ib = ia + 16;
                sa[j] = (ia <= sq && ia >= sq - 128) ? sa[j] * SC : -INFINITY;
                sb[j] = (ib <= sq && ib >= sq - 128) ? sb[j] * SC : -INFINITY;
                mx = fmaxf(mx, fmaxf(sa[j], sb[j]));
            }
            mx = fmaxf(mx, __shfl_xor(mx, 16)); mx = fmaxf(mx, __shfl_xor(mx, 32));
            const float mnew = fmaxf(mrun, mx), msafe = mnew == -INFINITY ? 0.f : mnew;
            const float alpha = fast_exp2(mrun - msafe);
            mrun = mnew;
            float ps = 0.f;
#pragma unroll
            for (int j = 0; j < 4; ++j) { sa[j] = fast_exp2(sa[j] - msafe); sb[j] = fast_exp2(sb[j] - msafe); ps += sa[j] + sb[j]; }
            lrun = lrun * alpha + ps;
#pragma unroll
            for (int i = 0; i < 4; ++i) o[i] = o[i] * alpha;
            u32x4 pw; pw.x = cvt_pk_bf16(sa[0], sa[1]); pw.y = cvt_pk_bf16(sa[2], sa[3]); pw.z = cvt_pk_bf16(sb[0], sb[1]); pw.w = cvt_pk_bf16(sb[2], sb[3]);
            const bf16x8 pb = __builtin_bit_cast(bf16x8, pw);
            asm volatile("s_waitcnt lgkmcnt(0)" ::: "memory");
#pragma unroll
            for (int dt = 0; dt < 4; ++dt) {
                const s16x4 l4 = vtr(vrd + dt * 32), h4 = vtr(vrd + 16 * 144 + dt * 32);
                const bf16x8 vf = (bf16x8){l4[0], l4[1], l4[2], l4[3], h4[0], h4[1], h4[2], h4[3]};
                o[dt] = __builtin_amdgcn_mfma_f32_16x16x32_bf16(vf, pb, o[dt], 0, 0, 0);
            }
            asm volatile("s_waitcnt lgkmcnt(0)" ::: "memory");
        }
    }
    lrun += __shfl_xor(lrun, 16); lrun += __shfl_xor(lrun, 32);
    const float inv = 1.0f / lrun;
    bf16_t* op = ao + ((size_t)b * T + tq) * 512 + h * 64 + 4 * fq;
#pragma unroll
    for (int dt = 0; dt < 4; ++dt) { const f32x4 x = o[dt] * inv; u32x2 w; w.x = cvt_pk_bf16(x[0], x[1]); w.y = cvt_pk_bf16(x[2], x[3]); *(u32x2*)(op + dt * 16) = w; }
}

__device__ void attn_sample_task(const Params& P, LAS float* wl, int bs, int h, int qi, int lane) {
    const bf16_t* qkvb = (const bf16_t*)(P.ws + WS_QKVB);
    const float SC = 0.125f * 1.44269504f;
    const int qrow = MP + bs * 8 + qi;
    LAS float* ql = wl; LAS float* sl = wl + 192;
#pragma unroll
    for (int g = 0; g < 3; ++g) ql[g * 64 + lane] = bf2f(qkvb[((size_t)((0 * 3 + g) * 8 + h) * M + qrow) * 64 + lane]);
    asm volatile("s_waitcnt lgkmcnt(0)" ::: "memory");
    float mx = -INFINITY;
#pragma unroll 1
    for (int g = 0; g < 3; ++g) {
        const int dsh = 2 * g, win = 128 << dsh;
        const float* cache = P.in[2 + g] + (size_t)bs * win * 1024 + h * 64;
        const bf16_t* kn = qkvb + ((size_t)((1 * 3 + g) * 8 + h) * M + MP + bs * 8) * 64;
        const LAS float* qg_ = ql + g * 64;
#pragma unroll 1
        for (int ps = 0; ps < 3; ++ps) {
            const int j = lane + 64 * ps;
            if (j <= 128) {
                const int idx = win + qi - (j << dsh); float a = 0.f;
                if (idx >= win) { const bf16_t* kr = kn + (size_t)(idx - win) * 64;
#pragma unroll
                    for (int c = 0; c < 8; ++c) { const u32x4 w = *(const u32x4*)(kr + c * 8); const LAS float* q = qg_ + c * 8;
                        a += q[0] * __uint_as_float(w.x << 16) + q[1] * __uint_as_float(w.x & 0xffff0000u) + q[2] * __uint_as_float(w.y << 16) + q[3] * __uint_as_float(w.y & 0xffff0000u)
                           + q[4] * __uint_as_float(w.z << 16) + q[5] * __uint_as_float(w.z & 0xffff0000u) + q[6] * __uint_as_float(w.w << 16) + q[7] * __uint_as_float(w.w & 0xffff0000u); }
                } else { const float* kr = cache + (size_t)idx * 1024;
#pragma unroll
                    for (int c = 0; c < 16; ++c) { const f32x4 w = *(const f32x4*)(kr + c * 4); const LAS float* q = qg_ + c * 4; a += q[0] * w[0] + q[1] * w[1] + q[2] * w[2] + q[3] * w[3]; } }
                a *= SC; sl[g * 192 + j] = a; mx = fmaxf(mx, a);
            }
        }
    }
    mx = wave_max(mx);
    float sum = 0.f;
#pragma unroll 1
    for (int g = 0; g < 3; ++g)
#pragma unroll 1
        for (int ps = 0; ps < 3; ++ps) { const int j = lane + 64 * ps; if (j <= 128) { const float p = fast_exp2(sl[g * 192 + j] - mx); sl[g * 192 + j] = p; sum += p; } }
    sum = wave_sum(sum);
    asm volatile("s_waitcnt lgkmcnt(0)" ::: "memory");
    float o = 0.f;
#pragma unroll 1
    for (int g = 0; g < 3; ++g) {
        const int dsh = 2 * g, win = 128 << dsh;
        const float* cache = P.in[2 + g] + (size_t)bs * win * 1024 + 512 + h * 64 + lane;
        const bf16_t* vn = qkvb + ((size_t)((2 * 3 + g) * 8 + h) * M + MP + bs * 8) * 64 + lane;
        const LAS float* pg_ = sl + g * 192;
#pragma unroll 1
        for (int jb = 0; jb < 128; jb += 8) {
            float vv[8];
#pragma unroll
            for (int e = 0; e < 8; ++e) { const int idx = win + qi - ((jb + e) << dsh); vv[e] = idx >= win ? bf2f(vn[(size_t)(idx - win) * 64]) : cache[(size_t)idx * 1024]; }
#pragma unroll
            for (int e = 0; e < 8; ++e) o += pg_[jb + e] * vv[e];
        }
        { const int idx = win + qi - (128 << dsh); const float v = idx >= win ? bf2f(vn[(size_t)(idx - win) * 64]) : cache[(size_t)idx * 1024]; o += pg_[128] * v; }
    }
    o /= sum;
    ((bf16_t*)(P.ws + WS_AO))[(size_t)qrow * 512 + h * 64 + lane] = f2bf(o);
}

__device__ void attn_phase(const Params& P, LAS unsigned char* lds) {
    const int tid = threadIdx.x, wid = tid >> 6, lane = tid & 63;
    const bf16_t* qkvb = (const bf16_t*)(P.ws + WS_QKVB); bf16_t* ao = (bf16_t*)(P.ws + WS_AO);
    LAS unsigned char* vl = lds + wid * 4608;
    for (int it = blockIdx.x * 8 + wid; it < 32 * 8 * 8; it += gridDim.x * 8) attn_sample_task(P, (LAS float*)(lds + 8 * 4608 + wid * 3072), it >> 6, (it >> 3) & 7, it & 7, lane);
    for (int it = blockIdx.x; it < NB * 8 * 16; it += gridDim.x) {
        const int blk = it & 15, h = (it >> 4) & 7, b = it >> 7;
        attn_prompt_task(qkvb, ao, vl, b, h, blk * 256 + wid, lane);
        attn_prompt_task(qkvb, ao, vl, b, h, blk * 256 + wid + 8, lane);
    }
}

__device__ void ssm_sample_task(const Params& P, int bs, int g, int lane) {
    const float dt = expf(P.in[15][g]);
    const float lr = P.in[13][g * 64 + lane], li = P.in[14][g * 64 + lane];
    const float e = expf(lr * dt); float sn, cs; sincosf(li * dt, &sn, &cs);
    const float ar = e * cs, ai = e * sn;
    const float nr = ar - 1.0f, ni = ai, den = 1.0f / (lr * lr + li * li);
    const float qr = (nr * lr + ni * li) * den, qi = (ni * lr - nr * li) * den;
    float bbr[16], bbi[16], cr[16], ci[16];
#pragma unroll
    for (int c = 0; c < 16; ++c) { const float br = P.in[16][((size_t)g * 64 + lane) * 16 + c], bi = P.in[17][((size_t)g * 64 + lane) * 16 + c];
        bbr[c] = qr * br - qi * bi; bbi[c] = qr * bi + qi * br; cr[c] = P.in[18][((size_t)g * 16 + c) * 64 + lane]; ci[c] = P.in[19][((size_t)g * 16 + c) * 64 + lane]; }
    const float* st = P.in[5] + (((size_t)bs * 64 + g) * 64 + lane) * 2;
    float xr = st[0], xi = st[1];
    const float* us = (const float*)(P.ws + WS_US);
    bf16_t* gb = (bf16_t*)(P.ws + WS_GB);
    const float dsk = P.in[20][g * 16 + (lane & 15)];
#pragma unroll 1
    for (int t = 0; t < 8; ++t) {
        const float* ur = us + (size_t)(bs * 8 + t) * D + g * 16;
        float bur = 0.f, bui = 0.f;
#pragma unroll
        for (int c = 0; c < 16; ++c) { const float uv = ur[c]; bur += bbr[c] * uv; bui += bbi[c] * uv; }
        const float nxr = ar * xr - ai * xi + bur, nxi = ar * xi + ai * xr + bui; xr = nxr; xi = nxi;
        float yv = 0.f;
#pragma unroll
        for (int c = 0; c < 16; ++c) { const float tot = wave_sum(cr[c] * xr - ci[c] * xi); if ((lane & 15) == c) yv = tot; }
        if (lane < 16) { const float y = yv + dsk * ur[lane]; gb[(size_t)(MP + bs * 8 + t) * D + g * 16 + lane] = f2bf(gelu_tanh(y)); }
    }
    float* so = P.out + O_STS + (((size_t)bs * 64 + g) * 64 + lane) * 2;
    so[0] = xr; so[1] = xi;
}

__device__ void ssm_scan_task(const Params& P, int b, int g, int lane) {
    const f32x2 a = ((const f32x2*)(P.ws + WS_A16))[g * 64 + lane];
    const f32x2* sl = (const f32x2*)(P.ws + WS_SLOC) + ((size_t)g * NCR + (size_t)b * 256) * 64 + lane;
    unsigned* ux = (unsigned*)((bf16_t*)(P.ws + WS_UX) + ((size_t)g * NCR + (size_t)b * 256) * UXP + 256) + lane;
    float xr = 0.f, xi = 0.f;
#pragma unroll 1
    for (int c = 0; c < 256; c += 8) {
        f32x2 s[8];
#pragma unroll
        for (int e = 0; e < 8; ++e) s[e] = sl[(size_t)(c + e) * 64];
#pragma unroll
        for (int e = 0; e < 8; ++e) {
            ux[(size_t)(c + e) * (UXP / 2)] = cvt_pk_bf16(xr, xi);
            const float nr = a.x * xr - a.y * xi + s[e].x, ni = a.x * xi + a.y * xr + s[e].y; xr = nr; xi = ni;
        }
    }
    float* so = P.out + O_STP + (((size_t)b * 64 + g) * 64 + lane) * 2;
    so[0] = xr; so[1] = xi;
}

__global__ void __launch_bounds__(512, 2) hybrid_fwd(Params P) {
    extern __shared__ __attribute__((aligned(16))) unsigned char smem[];
    LAS unsigned char* lds = (LAS unsigned char*)smem;
    cg::grid_group grid = cg::this_grid();
    const int G = gridDim.x, c = blockIdx.x, tid = threadIdx.x, wid = tid >> 6, lane = tid & 63;
    float* rowss = (float*)(P.ws + WS_ROWSS);
    bf16_t* xb = (bf16_t*)(P.ws + WS_XB);
    bf16_t* hff = (bf16_t*)(P.ws + WS_HFF);

    if (PH_MASK & 1) { for (int g = c; g < NG; g += G) prep_ssm(P, (LAS float*)lds, g);
    prep_weights(P, (LAS float*)lds);
    prep_misc(P); }
    grid.sync();
    if (PH_MASK & (1 << 1)) {
    { pg8::Gemm g{xb, (const bf16_t*)(P.ws + WS_WQKV), D, D, D}; pg8::StaticOrder S; S.init(M / 256, QKVW / 256, G, c);
      EpiQKV E{rowss, P.in[9], P.in[10], (const f32x2*)(P.ws + WS_ROPE), (bf16_t*)(P.ws + WS_QKVB), P.out};
      pg8::gemm_phase(lds, g, S, E); }
    }
    grid.sync();
    if (PH_MASK & (1 << 2)) {
    attn_phase(P, lds);
    }
    grid.sync();
    if (PH_MASK & (1 << 3)) {
    { pg8::Gemm g{(const bf16_t*)(P.ws + WS_AO), (const bf16_t*)(P.ws + WS_WO), 512, 512, 512}; pg8::StaticOrder S; S.init(M / 256, 4, G, c);
      EpiRes<0, true> E{P.in[0], P.in[1], P.out, xb, rowss + M};
      pg8::gemm_phase(lds, g, S, E); }
    }
    grid.sync();
    if (PH_MASK & (1 << 4)) {
    { pg8::Gemm g{xb, (const bf16_t*)(P.ws + WS_WGU0), D, D, D}; pg8::StaticOrder S; S.init(M / 256, 2 * DFF / 256, G, c);
      EpiUp E{rowss + M, hff};
      pg8::gemm_phase(lds, g, S, E); }
    }
    grid.sync();
    if (PH_MASK & (1 << 5)) {
    { pg8::Gemm g{hff, (const bf16_t*)(P.ws + WS_WDN0), DFF, DFF, DFF}; pg8::StaticOrder S; S.init(M / 256, 4, G, c);
      EpiRes<0, true> E{P.out, P.out + O_YS, P.out, xb, rowss + 2 * M};
      pg8::gemm_phase(lds, g, S, E); }
    }
    grid.sync();
    if (PH_MASK & (1 << 6)) {
    { pg8::Gemm g{xb, (const bf16_t*)(P.ws + WS_WIN), D, D, D}; pg8::StaticOrder S; S.init(M / 256, 4, G, c);
      EpiWin E{rowss + 2 * M, (bf16_t*)(P.ws + WS_UX), (float*)(P.ws + WS_US)};
      pg8::gemm_phase(lds, g, S, E); }
    }
    grid.sync();
    if (PH_MASK & (1 << 7)) {
    { pg8::Gemm g{(const bf16_t*)(P.ws + WS_UX), (const bf16_t*)(P.ws + WS_BTS), UXP, 256, 256}; pg8::GroupOrder S{G, c};
      EpiSloc E{(float*)(P.ws + WS_SLOC)};
      pg8::gemm_phase(lds, g, S, E); }
    for (int it = c * 8 + wid; it < 32 * NG; it += G * 8) ssm_sample_task(P, it >> 6, it & 63, lane);
    }
    grid.sync();
    if (PH_MASK & (1 << 8)) {
    for (int it = c * 8 + wid; it < NB * NG; it += G * 8) ssm_scan_task(P, it >> 6, it & 63, lane);
    }
    grid.sync();
    if (PH_MASK & (1 << 9)) {
    { pg8::Gemm g{(const bf16_t*)(P.ws + WS_UX), (const bf16_t*)(P.ws + WS_BTY), UXP, UXP, UXP}; pg8::GroupOrder S{G, c};
      EpiY E{(const bf16_t*)(P.ws + WS_UX), P.in[20], (bf16_t*)(P.ws + WS_GB)};
      pg8::gemm_phase(lds, g, S, E); }
    }
    grid.sync();
    if (PH_MASK & (1 << 10)) {
    { pg8::Gemm g{(const bf16_t*)(P.ws + WS_GB), (const bf16_t*)(P.ws + WS_WGLU), D, D, D}; pg8::StaticOrder S; S.init(M / 256, 8, G, c);
      EpiRes<1, true> E{P.out, P.out + O_YS, P.out, xb, rowss + 3 * M};
      pg8::gemm_phase(lds, g, S, E); }
    }
    grid.sync();
    if (PH_MASK & (1 << 11)) {
    { pg8::Gemm g{xb, (const bf16_t*)(P.ws + WS_WGU1), D, D, D}; pg8::StaticOrder S; S.init(M / 256, 2 * DFF / 256, G, c);
      EpiUp E{rowss + 3 * M, hff};
      pg8::gemm_phase(lds, g, S, E); }
    }
    grid.sync();
    if (PH_MASK & (1 << 12)) {
    { pg8::Gemm g{hff, (const bf16_t*)(P.ws + WS_WDN1), DFF, DFF, DFF}; pg8::StaticOrder S; S.init(M / 256, 4, G, c);
      EpiRes<0, false> E{P.out, P.out + O_YS, P.out, nullptr, nullptr};
      pg8::gemm_phase(lds, g, S, E); }
    }
}

extern "C" void kernel_launch(void* const* d_in, const int* in_sizes, int n_in, void* d_out, int out_size, void* d_ws, size_t ws_size, hipStream_t stream) {
    static int grid_blocks = 0;
    if (grid_blocks == 0) {
        if (n_in != 25 || (size_t)out_size != O_END || ws_size < WS_END) { fprintf(stderr, "kernel_launch: unexpected shapes: n_in %d out %d (want %zu) ws %zu (need %zu)\n", n_in, out_size, (size_t)O_END, ws_size, (size_t)WS_END); grid_blocks = -1; return; }
        int dev = 0, cus = 0, per_cu = 0;
        hipGetDevice(&dev);
        hipDeviceGetAttribute(&cus, hipDeviceAttributeMultiprocessorCount, dev);
        if (hipFuncSetAttribute((const void*)hybrid_fwd, hipFuncAttributeMaxDynamicSharedMemorySize, LDS_BYTES) != hipSuccess) { fprintf(stderr, "kernel_launch: hipFuncSetAttribute failed\n"); grid_blocks = -1; return; }
        if (hipOccupancyMaxActiveBlocksPerMultiprocessor(&per_cu, (const void*)hybrid_fwd, 512, LDS_BYTES) != hipSuccess || per_cu < 1) { fprintf(stderr, "kernel_launch: occupancy query failed (%d)\n", per_cu); grid_blocks = -1; return; }
        grid_blocks = cus * per_cu;
    }
    if (grid_blocks < 0) return;
    Params p{};
    for (int i = 0; i < 25; ++i) p.in[i] = (const float*)d_in[i];
    p.out = (float*)d_out; p.ws = (unsigned char*)d_ws;
    void* args[] = {&p};
    hipError_t e = hipLaunchCooperativeKernel((const void*)hybrid_fwd, dim3(grid_blocks), dim3(512), args, LDS_BYTES, stream);
    if (e != hipSuccess) fprintf(stderr, "cooperative launch failed: %s (grid %d)\n", hipGetErrorString(e), grid_blocks);
}
```
